# Optimizing an MI355X kernel written in HIP

```python
import math
import jax, jax.numpy as jnp
from jax import lax
import numpy as np


D_MODEL = 1024
BATCH = 8
SEQ = 2048
DEPTH = 1

MEM_LEN = 256
S5_WIDTH = 512
S5_GROUP = 16
S5_GROUPS = S5_WIDTH // S5_GROUP
S5_STATE = 64
DT_MIN = 1e-3
DT_MAX = 1e-1
DIFF_WIDTH = D_MODEL - S5_WIDTH
DIFF_HEAD_DIM = 64
DIFF_V_DIM = 2 * DIFF_HEAD_DIM
N_DIFF_HEADS = DIFF_WIDTH // DIFF_V_DIM
DIFF_QK_WIDTH = 2 * N_DIFF_HEADS * DIFF_HEAD_DIM
MIX_WIDTH = S5_WIDTH + DIFF_WIDTH
MIX_IN = S5_WIDTH + 2 * DIFF_QK_WIDTH + DIFF_WIDTH
Q_BLOCK = 128
NUM_BUCKETS = 32
MAX_DISTANCE = 128
CA_HEADS = 4
CA_HEAD_DIM = D_MODEL // CA_HEADS
FFN_HIDDEN = -(-8 * D_MODEL // (3 * 256)) * 256
DEEPNORM_ALPHA = (2.0 * DEPTH) ** 0.25
DEEPNORM_BETA = (8.0 * DEPTH) ** -0.25
LN_EPS = 1e-5

kernel_name = "hymba_s5_diffattn_deepnorm_layer"


def layer_norm(x, g, b):
    xf = x.astype(jnp.float32)
    mu = jnp.mean(xf, axis=-1, keepdims=True)
    var = jnp.mean(jnp.square(xf - mu), axis=-1, keepdims=True)
    y = (xf - mu) * lax.rsqrt(var + LN_EPS)
    return (y * g.astype(jnp.float32) + b.astype(jnp.float32)).astype(x.dtype)


def rms_norm(x, g):
    xf = x.astype(jnp.float32)
    y = xf * lax.rsqrt(jnp.mean(jnp.square(xf), axis=-1, keepdims=True) + LN_EPS)
    return (y * g.astype(jnp.float32)).astype(x.dtype)


def cmul(ar, ai, br, bi):
    return ar * br - ai * bi, ar * bi + ai * br


def s5_mixer(u, lam_re, lam_im, log_dt, b_re, b_im, c_re, c_im, d, glu_w, glu_b):
    f32 = jnp.float32
    bsz, seq, _ = u.shape
    uf = u.astype(f32).reshape(bsz, seq, S5_GROUPS, S5_GROUP)
    dt = jnp.exp(log_dt.astype(f32))[:, None]
    lr, li = lam_re.astype(f32), lam_im.astype(f32)
    mag = jnp.exp(lr * dt)
    ang = li * dt
    ab_re, ab_im = mag * jnp.cos(ang), mag * jnp.sin(ang)
    den = lr * lr + li * li
    nr, ni = ab_re - 1.0, ab_im
    f_re = (nr * lr + ni * li) / den
    f_im = (ni * lr - nr * li) / den
    bb_re, bb_im = cmul(f_re[..., None], f_im[..., None], b_re.astype(f32), b_im.astype(f32))
    bu_re = jnp.einsum('blgh,gph->blgp', uf, bb_re)
    bu_im = jnp.einsum('blgh,gph->blgp', uf, bb_im)
    a_re = jnp.broadcast_to(ab_re, bu_re.shape)
    a_im = jnp.broadcast_to(ab_im, bu_im.shape)

    def combine(e1, e2):
        a1r, a1i, b1r, b1i = e1
        a2r, a2i, b2r, b2i = e2
        ar, ai = cmul(a2r, a2i, a1r, a1i)
        br, bi = cmul(a2r, a2i, b1r, b1i)
        return ar, ai, br + b2r, bi + b2i

    _, _, xr, xi = lax.associative_scan(combine, (a_re, a_im, bu_re, bu_im), axis=1)
    y = (jnp.einsum('ghp,blgp->blgh', c_re.astype(f32), xr)
         - jnp.einsum('ghp,blgp->blgh', c_im.astype(f32), xi)
         + d.astype(f32) * uf)
    y = jax.nn.gelu(y.reshape(bsz, seq, S5_WIDTH))
    y = y * jax.nn.sigmoid(y @ glu_w.astype(f32) + glu_b.astype(f32))
    return y.astype(u.dtype)


def t5_bucket(dist):
    max_exact = NUM_BUCKETS // 2
    is_small = dist < max_exact
    df = jnp.maximum(dist, 1).astype(jnp.float32)
    large = max_exact + (jnp.log(df / max_exact) / math.log(MAX_DISTANCE / max_exact)
                         * (NUM_BUCKETS - max_exact)).astype(jnp.int32)
    large = jnp.minimum(large, NUM_BUCKETS - 1)
    return jnp.where(is_small, dist, large)


def diff_attention(q, k, v, rel_bias, lq1, lk1, lq2, lk2, subln_g, lambda_init):
    f32 = jnp.float32
    bsz, seq = q.shape[0], q.shape[1]
    lam = (jnp.exp(jnp.sum(lq1.astype(f32) * lk1.astype(f32)))
           - jnp.exp(jnp.sum(lq2.astype(f32) * lk2.astype(f32))) + lambda_init)
    scale = DIFF_HEAD_DIM ** -0.5
    outs = []
    for start in range(0, seq, Q_BLOCK):
        end = start + Q_BLOCK
        qb, kb, vb = q[:, start:end], k[:, :end], v[:, :end]
        s = jnp.einsum('bqhd,bkhd->bhqk', qb, kb).astype(f32) * scale
        s = s.reshape(bsz, N_DIFF_HEADS, 2, Q_BLOCK, end)
        dist = jnp.arange(start, end, dtype=jnp.int32)[:, None] - jnp.arange(end, dtype=jnp.int32)[None, :]
        bias = jnp.transpose(rel_bias.astype(f32)[t5_bucket(jnp.maximum(dist, 0))], (2, 0, 1))
        s = jnp.where(dist >= 0, s + bias[None, :, None], -jnp.inf)
        p = jax.nn.softmax(s, axis=-1)
        attn = p[:, :, 0] - lam * p[:, :, 1]
        outs.append(jnp.einsum('bhqk,bkhd->bqhd', attn.astype(v.dtype), vb))
    o = jnp.concatenate(outs, axis=1)
    o = rms_norm(o, subln_g) * (1.0 - lambda_init)
    return o.reshape(bsz, seq, DIFF_WIDTH)


def memory_cross_attention(h, mem, wq, wkv, wo):
    f32 = jnp.float32
    bsz, seq, _ = h.shape
    q = (h @ wq).reshape(bsz, seq, CA_HEADS, CA_HEAD_DIM)
    kv = mem @ wkv
    k = kv[..., :D_MODEL].reshape(bsz, mem.shape[1], CA_HEADS, CA_HEAD_DIM)
    v = kv[..., D_MODEL:].reshape(bsz, mem.shape[1], CA_HEADS, CA_HEAD_DIM)
    s = jnp.einsum('bqhd,bkhd->bhqk', q, k).astype(f32) * (CA_HEAD_DIM ** -0.5)
    p = jax.nn.softmax(s, axis=-1).astype(v.dtype)
    o = jnp.einsum('bhqk,bkhd->bqhd', p, v).reshape(bsz, seq, D_MODEL)
    return o @ wo


def swiglu_ffn(h, w_gate_up, w_down):
    gu = h @ w_gate_up
    return (jax.nn.silu(gu[..., :FFN_HIDDEN]) * gu[..., FFN_HIDDEN:]) @ w_down


def setup_inputs(seed: int = 0) -> dict:
    key = jax.random.key(seed)
    ks = jax.random.split(key, 40)
    f32 = jnp.float32

    def nrm(k, shape, s):
        return s * jax.random.normal(k, shape, f32)

    L = DEPTH
    return {
        "x": nrm(ks[0], (BATCH, SEQ, D_MODEL), 1.0),
        "mem": nrm(ks[1], (BATCH, MEM_LEN, D_MODEL), 1.0),
        "ln_in_g": 1.0 + nrm(ks[2], (D_MODEL,), 0.02),
        "ln_in_b": nrm(ks[3], (D_MODEL,), 0.02),
        "w_in": nrm(ks[4], (L, D_MODEL, MIX_IN), D_MODEL ** -0.5),
        "s5_lambda_re": -0.5 + nrm(ks[5], (L, S5_GROUPS, S5_STATE), 0.01),
        "s5_lambda_im": math.pi * jnp.arange(S5_STATE, dtype=f32) + nrm(ks[6], (L, S5_GROUPS, S5_STATE), 0.01),
        "s5_log_dt": jax.random.uniform(ks[7], (L, S5_GROUPS), f32, math.log(DT_MIN), math.log(DT_MAX)),
        "s5_b_re": nrm(ks[8], (L, S5_GROUPS, S5_STATE, S5_GROUP), (2.0 * S5_GROUP) ** -0.5),
        "s5_b_im": nrm(ks[9], (L, S5_GROUPS, S5_STATE, S5_GROUP), (2.0 * S5_GROUP) ** -0.5),
        "s5_c_re": nrm(ks[10], (L, S5_GROUPS, S5_GROUP, S5_STATE), S5_STATE ** -0.5),
        "s5_c_im": nrm(ks[11], (L, S5_GROUPS, S5_GROUP, S5_STATE), S5_STATE ** -0.5),
        "s5_d": nrm(ks[12], (L, S5_GROUPS, S5_GROUP), 1.0),
        "s5_glu_w": nrm(ks[13], (L, S5_WIDTH, S5_WIDTH), S5_WIDTH ** -0.5),
        "s5_glu_b": nrm(ks[14], (L, S5_WIDTH), 0.01),
        "diff_lq1": nrm(ks[15], (L, DIFF_HEAD_DIM), 0.1),
        "diff_lk1": nrm(ks[16], (L, DIFF_HEAD_DIM), 0.1),
        "diff_lq2": nrm(ks[17], (L, DIFF_HEAD_DIM), 0.1),
        "diff_lk2": nrm(ks[18], (L, DIFF_HEAD_DIM), 0.1),
        "diff_subln_g": 1.0 + nrm(ks[19], (L, DIFF_V_DIM), 0.02),
        "rel_bias": nrm(ks[20], (NUM_BUCKETS, N_DIFF_HEADS), 0.2),
        "w_out": nrm(ks[21], (L, MIX_WIDTH, D_MODEL), DEEPNORM_BETA * MIX_WIDTH ** -0.5),
        "ln1_g": 1.0 + nrm(ks[22], (L, D_MODEL), 0.02),
        "ln1_b": nrm(ks[23], (L, D_MODEL), 0.02),
        "ca_wq": nrm(ks[24], (L, D_MODEL, D_MODEL), D_MODEL ** -0.5),
        "ca_wkv": nrm(ks[25], (L, D_MODEL, 2 * D_MODEL), D_MODEL ** -0.5),
        "ca_wo": nrm(ks[26], (L, D_MODEL, D_MODEL), DEEPNORM_BETA * D_MODEL ** -0.5),
        "ln2_g": 1.0 + nrm(ks[27], (L, D_MODEL), 0.02),
        "ln2_b": nrm(ks[28], (L, D_MODEL), 0.02),
        "ffn_w_gate_up": nrm(ks[29], (L, D_MODEL, 2 * FFN_HIDDEN), D_MODEL ** -0.5),
        "ffn_w_down": nrm(ks[30], (L, FFN_HIDDEN, D_MODEL), DEEPNORM_BETA * FFN_HIDDEN ** -0.5),
        "ln3_g": 1.0 + nrm(ks[31], (L, D_MODEL), 0.02),
        "ln3_b": nrm(ks[32], (L, D_MODEL), 0.02),
    }


def reference(x, mem, ln_in_g, ln_in_b, w_in, s5_lambda_re, s5_lambda_im, s5_log_dt,
              s5_b_re, s5_b_im, s5_c_re, s5_c_im, s5_d, s5_glu_w, s5_glu_b,
              diff_lq1, diff_lk1, diff_lq2, diff_lk2, diff_subln_g, rel_bias, w_out,
              ln1_g, ln1_b, ca_wq, ca_wkv, ca_wo, ln2_g, ln2_b,
              ffn_w_gate_up, ffn_w_down, ln3_g, ln3_b):
    bsz, seq, _ = x.shape
    h = layer_norm(x, ln_in_g, ln_in_b)
    for l in range(DEPTH):
        lambda_init = 0.8 - 0.6 * math.exp(-0.3 * l)
        proj = h @ w_in[l]
        u = proj[..., :S5_WIDTH]
        q = proj[..., S5_WIDTH:S5_WIDTH + DIFF_QK_WIDTH].reshape(bsz, seq, 2 * N_DIFF_HEADS, DIFF_HEAD_DIM)
        k = proj[..., S5_WIDTH + DIFF_QK_WIDTH:S5_WIDTH + 2 * DIFF_QK_WIDTH].reshape(bsz, seq, 2 * N_DIFF_HEADS, DIFF_HEAD_DIM)
        v = proj[..., S5_WIDTH + 2 * DIFF_QK_WIDTH:].reshape(bsz, seq, N_DIFF_HEADS, DIFF_V_DIM)
        y_s5 = s5_mixer(u, s5_lambda_re[l], s5_lambda_im[l], s5_log_dt[l], s5_b_re[l], s5_b_im[l],
                        s5_c_re[l], s5_c_im[l], s5_d[l], s5_glu_w[l], s5_glu_b[l])
        y_diff = diff_attention(q, k, v, rel_bias, diff_lq1[l], diff_lk1[l], diff_lq2[l], diff_lk2[l],
                                diff_subln_g[l], lambda_init)
        mix = jnp.concatenate([y_s5, y_diff], axis=-1) @ w_out[l]
        h = layer_norm(DEEPNORM_ALPHA * h + mix, ln1_g[l], ln1_b[l])
        h = layer_norm(DEEPNORM_ALPHA * h + memory_cross_attention(h, mem, ca_wq[l], ca_wkv[l], ca_wo[l]),
                       ln2_g[l], ln2_b[l])
        h = layer_norm(DEEPNORM_ALPHA * h + swiglu_ffn(h, ffn_w_gate_up[l], ffn_w_down[l]),
                       ln3_g[l], ln3_b[l])
    return h
```

```cpp
#include <hip/hip_runtime.h>
#include <cstdio>
#include <cstdint>
#include <cmath>

namespace nv {
constexpr int D = 1024, B = 8, L = 2048, M = B * L, MEM = 256, MM = B * MEM;
constexpr int S5W = 512, G = 32, GH = 16, P = 64;
constexpr int NH = 4, DH = 64, DV = 128, MIXIN = 2048, FF = 2816;
constexpr float ALPHA = 1.189207115002721f, EPS = 1e-5f;

__device__ const unsigned char BUCKET[128] = {0, 1, 2, 3, 4, 5, 6, 7, 8, 9, 10, 11, 12, 13, 14, 15, 16, 16, 16, 17, 17, 18, 18, 18, 19, 19, 19, 20, 20, 20, 20, 21, 21, 21, 21, 22, 22, 22, 22, 22, 23, 23, 23, 23, 23, 23, 24, 24, 24, 24, 24, 24, 25, 25, 25, 25, 25, 25, 25, 26, 26, 26, 26, 26, 26, 26, 26, 27, 27, 27, 27, 27, 27, 27, 27, 27, 27, 28, 28, 28, 28, 28, 28, 28, 28, 28, 28, 29, 29, 29, 29, 29, 29, 29, 29, 29, 29, 29, 29, 30, 30, 30, 30, 30, 30, 30, 30, 30, 30, 30, 30, 30, 30, 31, 31, 31, 31, 31, 31, 31, 31, 31, 31, 31, 31, 31, 31, 31};

__device__ __forceinline__ float wsum(float v) {
#pragma unroll
    for (int o = 1; o < 64; o <<= 1) v += __shfl_xor(v, o);
    return v;
}
__device__ __forceinline__ float wmax(float v) {
#pragma unroll
    for (int o = 1; o < 64; o <<= 1) v = fmaxf(v, __shfl_xor(v, o));
    return v;
}

__global__ void __launch_bounds__(256) ln_rows(const float* a, const float* r, float alpha, const float* g, const float* b, float* out, int rows) {
    const int row = blockIdx.x * 4 + (threadIdx.x >> 6), lane = threadIdx.x & 63;
    if (row >= rows) return;
    float v[16]; float s = 0.f;
#pragma unroll
    for (int j = 0; j < 16; ++j) { const int c = j * 64 + lane; float x = alpha * a[(size_t)row * D + c]; if (r) x += r[(size_t)row * D + c]; v[j] = x; s += x; }
    const float mean = wsum(s) * (1.f / D); float q = 0.f;
#pragma unroll
    for (int j = 0; j < 16; ++j) { v[j] -= mean; q += v[j] * v[j]; }
    const float rstd = 1.0f / sqrtf(wsum(q) * (1.f / D) + EPS);
#pragma unroll
    for (int j = 0; j < 16; ++j) { const int c = j * 64 + lane; out[(size_t)row * D + c] = v[j] * rstd * g[c] + b[c]; }
}

__global__ void __launch_bounds__(256) gemm_f32(const float* A, int lda, const float* W, int ldw, float* C, int ldc, int K) {
    __shared__ float As[16][65], Ws[16][65];
    const int tx = threadIdx.x & 15, ty = threadIdx.x >> 4, m0 = blockIdx.y * 64, n0 = blockIdx.x * 64;
    float acc[4][4] = {};
    for (int k0 = 0; k0 < K; k0 += 16) {
#pragma unroll
        for (int i = 0; i < 4; ++i) { const int e = threadIdx.x + i * 256; const int r = e >> 4, c = e & 15; As[c][r] = A[(size_t)(m0 + r) * lda + k0 + c]; }
#pragma unroll
        for (int i = 0; i < 4; ++i) { const int e = threadIdx.x + i * 256; const int r = e >> 6, c = e & 63; Ws[r][c] = W[(size_t)(k0 + r) * ldw + n0 + c]; }
        __syncthreads();
#pragma unroll
        for (int k = 0; k < 16; ++k) { float a[4], w[4];
#pragma unroll
            for (int i = 0; i < 4; ++i) { a[i] = As[k][ty * 4 + i]; w[i] = Ws[k][tx * 4 + i]; }
#pragma unroll
            for (int i = 0; i < 4; ++i)
#pragma unroll
                for (int j = 0; j < 4; ++j) acc[i][j] += a[i] * w[j]; }
        __syncthreads();
    }
#pragma unroll
    for (int i = 0; i < 4; ++i)
#pragma unroll
        for (int j = 0; j < 4; ++j) C[(size_t)(m0 + ty * 4 + i) * ldc + n0 + tx * 4 + j] = acc[i][j];
}

__device__ __forceinline__ float gelu_tanh(float x) { const float u = 0.7978845608028654f * (x + 0.044715f * x * x * x); return 0.5f * x * (1.f + tanhf(u)); }

__global__ void __launch_bounds__(64) s5_naive(const float* proj, const float* lam_re, const float* lam_im, const float* log_dt, const float* b_re, const float* b_im,
                                               const float* c_re, const float* c_im, const float* dd, float* yout) {
    const int g = blockIdx.x % G, b = blockIdx.x / G, p = threadIdx.x;
    const float dt = expf(log_dt[g]); const float lr = lam_re[g * P + p], li = lam_im[g * P + p];
    const float mag = expf(lr * dt), ang = li * dt; const float are = mag * cosf(ang), aim = mag * sinf(ang);
    const float den = lr * lr + li * li, nr = are - 1.f, ni = aim; const float fre = (nr * lr + ni * li) / den, fim = (ni * lr - nr * li) / den;
    float bbr[16], bbi[16], cr[16], ci[16];
#pragma unroll
    for (int h = 0; h < 16; ++h) { const float br = b_re[(g * P + p) * GH + h], bi = b_im[(g * P + p) * GH + h]; bbr[h] = fre * br - fim * bi; bbi[h] = fre * bi + fim * br;
        cr[h] = c_re[(g * GH + h) * P + p]; ci[h] = c_im[(g * GH + h) * P + p]; }
    const float dmy = (p < 16) ? dd[g * GH + p] : 0.f;
    float xr = 0.f, xi = 0.f;
    for (int t = 0; t < L; ++t) {
        const float* u = proj + (size_t)(b * L + t) * MIXIN + g * GH;
        float bur = 0.f, bui = 0.f;
#pragma unroll
        for (int h = 0; h < 16; ++h) { const float uh = u[h]; bur += bbr[h] * uh; bui += bbi[h] * uh; }
        const float nxr = are * xr - aim * xi + bur, nxi = are * xi + aim * xr + bui; xr = nxr; xi = nxi;
        float mine = 0.f;
#pragma unroll
        for (int h = 0; h < 16; ++h) { const float y = wsum(cr[h] * xr - ci[h] * xi); if (p == h) mine = y; }
        if (p < 16) { const float y = mine + dmy * u[p]; yout[(size_t)(b * L + t) * S5W + g * GH + p] = gelu_tanh(y); }
    }
}
__global__ void glu_apply(const float* y, const float* z, const float* bias, float* out, int ldo) {
    const size_t i = (size_t)blockIdx.x * blockDim.x + threadIdx.x; if (i >= (size_t)M * S5W) return;
    const int c = (int)(i % S5W); const size_t m = i / S5W; const float yy = y[i]; out[m * ldo + c] = yy / (1.f + expf(-(z[i] + bias[c])));
}

__global__ void __launch_bounds__(64) diffattn_naive(const float* proj, const float* rel_bias, const float* lq1, const float* lk1, const float* lq2, const float* lk2, const float* subg, float* mixin) {
    __shared__ float sc[2][L];
    __shared__ float qs[2][DH];
    const int q = blockIdx.x % L, h = (blockIdx.x / L) % NH, b = blockIdx.x / (L * NH), lane = threadIdx.x;
    float d1 = lq1[lane] * lk1[lane], d2 = lq2[lane] * lk2[lane];
    const float lam = expf(wsum(d1)) - expf(wsum(d2)) + 0.2f;
    const float* prow = proj + (size_t)(b * L + q) * MIXIN;
    qs[0][lane] = prow[512 + (2 * h) * 64 + lane]; qs[1][lane] = prow[512 + (2 * h + 1) * 64 + lane];
    __syncthreads();
    float mx[2] = {-INFINITY, -INFINITY};
    for (int k = lane; k <= q; k += 64) {
        const float* krow = proj + (size_t)(b * L + k) * MIXIN + 1024 + (2 * h) * 64;
        float s0 = 0.f, s1 = 0.f;
        for (int d = 0; d < DH; ++d) { s0 += qs[0][d] * krow[d]; s1 += qs[1][d] * krow[64 + d]; }
        const int dist = q - k; const int bk = dist < 128 ? BUCKET[dist] : 31; const float bias = rel_bias[bk * NH + h];
        s0 = s0 * 0.125f + bias; s1 = s1 * 0.125f + bias; sc[0][k] = s0; sc[1][k] = s1; mx[0] = fmaxf(mx[0], s0); mx[1] = fmaxf(mx[1], s1);
    }
    mx[0] = wmax(mx[0]); mx[1] = wmax(mx[1]);
    float l0 = 0.f, l1 = 0.f;
    for (int k = lane; k <= q; k += 64) { const float e0 = expf(sc[0][k] - mx[0]), e1 = expf(sc[1][k] - mx[1]); sc[0][k] = e0; sc[1][k] = e1; l0 += e0; l1 += e1; }
    l0 = wsum(l0); l1 = wsum(l1);
    __syncthreads();
    const float i0 = 1.f / l0, i1 = lam / l1;
    float o0 = 0.f, o1 = 0.f;
    for (int k = 0; k <= q; ++k) { const float a = sc[0][k] * i0 - sc[1][k] * i1; const float* vrow = proj + (size_t)(b * L + k) * MIXIN + 1536 + h * DV; o0 += a * vrow[lane]; o1 += a * vrow[64 + lane]; }
    const float ms = wsum(o0 * o0 + o1 * o1) * (1.f / DV); const float r = 1.0f / sqrtf(ms + EPS);
    float* orow = mixin + (size_t)(b * L + q) * D + 512 + h * DV;
    orow[lane] = o0 * r * subg[lane] * 0.8f; orow[64 + lane] = o1 * r * subg[64 + lane] * 0.8f;
}

__global__ void __launch_bounds__(64) crossattn_naive(const float* qca, const float* kv, float* out) {
    __shared__ float sc[MEM];
    const int q = blockIdx.x % L, hd = (blockIdx.x / L) % 4, b = blockIdx.x / (L * 4), lane = threadIdx.x;
    const float4 qv = *(const float4*)(qca + (size_t)(b * L + q) * D + hd * 256 + lane * 4);
    for (int k = 0; k < MEM; ++k) { const float4 kk = *(const float4*)(kv + (size_t)(b * MEM + k) * 2048 + hd * 256 + lane * 4);
        const float s = wsum(qv.x * kk.x + qv.y * kk.y + qv.z * kk.z + qv.w * kk.w) * 0.0625f; if (lane == 0) sc[k] = s; }
    __syncthreads();
    float mx = -INFINITY;
    for (int k = lane; k < MEM; k += 64) mx = fmaxf(mx, sc[k]);
    mx = wmax(mx); float l = 0.f;
    for (int k = lane; k < MEM; k += 64) { const float e = expf(sc[k] - mx); sc[k] = e; l += e; }
    l = wsum(l); __syncthreads();
    const float il = 1.f / l; float4 o = {0.f, 0.f, 0.f, 0.f};
    for (int k = 0; k < MEM; ++k) { const float pk = sc[k] * il; const float4 vv = *(const float4*)(kv + (size_t)(b * MEM + k) * 2048 + 1024 + hd * 256 + lane * 4);
        o.x += pk * vv.x; o.y += pk * vv.y; o.z += pk * vv.z; o.w += pk * vv.w; }
    *(float4*)(out + (size_t)(b * L + q) * D + hd * 256 + lane * 4) = o;
}
__global__ void swiglu_apply(const float* gu, float* act, int rows) {
    const size_t i = (size_t)blockIdx.x * blockDim.x + threadIdx.x; if (i >= (size_t)rows * FF) return;
    const int c = (int)(i % FF); const size_t m = i / FF; const float gg = gu[m * 2 * FF + c], uu = gu[m * 2 * FF + FF + c]; act[i] = gg / (1.f + expf(-gg)) * uu;
}

static void gemm(const float* A, int lda, const float* W, int ldw, float* C, int ldc, int Mr, int N, int K, hipStream_t s) {
    hipLaunchKernelGGL(gemm_f32, dim3(N / 64, Mr / 64), dim3(256), 0, s, A, lda, W, ldw, C, ldc, K);
}

static void forward(void* const* d_in, float* out, unsigned char* ws, hipStream_t s) {
    const float* x = (const float*)d_in[0]; const float* mem = (const float*)d_in[1];
#define IN(i) ((const float*)d_in[i])
    float* A = (float*)ws;
    float* Bf = (float*)(ws + (size_t)64 * 1048576);
    float* C = (float*)(ws + (size_t)192 * 1048576);
    hipLaunchKernelGGL(ln_rows, dim3(M / 4), dim3(256), 0, s, x, (const float*)nullptr, 1.0f, IN(2), IN(3), A, M);
    gemm(A, D, IN(4), MIXIN, Bf, MIXIN, M, MIXIN, D, s);
    float* ytmp = out; float* ztmp = out + (size_t)M * S5W;
    hipLaunchKernelGGL(s5_naive, dim3(B * G), dim3(64), 0, s, Bf, IN(5), IN(6), IN(7), IN(8), IN(9), IN(10), IN(11), IN(12), ytmp);
    gemm(ytmp, S5W, IN(13), S5W, ztmp, S5W, M, S5W, S5W, s);
    hipLaunchKernelGGL(glu_apply, dim3((M * S5W + 255) / 256), dim3(256), 0, s, ytmp, ztmp, IN(14), C, D);
    hipLaunchKernelGGL(diffattn_naive, dim3(B * NH * L), dim3(64), 0, s, Bf, IN(20), IN(15), IN(16), IN(17), IN(18), IN(19), C);
    gemm(C, D, IN(21), D, Bf, D, M, D, D, s);
    hipLaunchKernelGGL(ln_rows, dim3(M / 4), dim3(256), 0, s, A, Bf, ALPHA, IN(22), IN(23), A, M);
    float* kvb = Bf + (size_t)M * D;
    gemm(A, D, IN(24), D, Bf, D, M, D, D, s);
    gemm(mem, D, IN(25), 2048, kvb, 2048, MM, 2048, D, s);
    hipLaunchKernelGGL(crossattn_naive, dim3(B * 4 * L), dim3(64), 0, s, Bf, kvb, C);
    gemm(C, D, IN(26), D, Bf, D, M, D, D, s);
    hipLaunchKernelGGL(ln_rows, dim3(M / 4), dim3(256), 0, s, A, Bf, ALPHA, IN(27), IN(28), A, M);
    for (int ch = 0; ch < 4; ++ch) { const int r0 = ch * 4096;
        gemm(A + (size_t)r0 * D, D, IN(29), 2 * FF, Bf, 2 * FF, 4096, 2 * FF, D, s);
        hipLaunchKernelGGL(swiglu_apply, dim3((4096 * FF + 255) / 256), dim3(256), 0, s, Bf, C, 4096);
        gemm(C, FF, IN(30), D, out + (size_t)r0 * D, D, 4096, D, FF, s); }
    hipLaunchKernelGGL(ln_rows, dim3(M / 4), dim3(256), 0, s, A, out, ALPHA, IN(31), IN(32), out, M);
#undef IN
}
}

extern "C" void kernel_launch(void* const* d_in, const int* in_sizes, int n_in, void* d_out, int out_size, void* d_ws, size_t ws_size, hipStream_t stream) {
    if (n_in != 33 || out_size != nv::M * nv::D || ws_size < (size_t)256 * 1048576) { fprintf(stderr, "kernel_launch: unexpected shapes n_in %d out %d ws %zu\n", n_in, out_size, ws_size); return; }
    nv::forward(d_in, (float*)d_out, (unsigned char*)d_ws, stream);
}
```
